# Optimizing an MI355X kernel written in HIP

```python
import math
import numpy as np
import jax
import jax.numpy as jnp
from jax import lax

D_MODEL = 1024
BATCH = 8
SEQ = 2048
DEPTH = 1

CHUNK = 64
HEAD_DIM = 64
D_FF = 2816
EPS = 1e-6
NEG_INF = -1e30
H_A = 8
KV_A = 2
G_A = H_A // KV_A
WINDOW_A = 128
BACK_A = WINDOW_A // CHUNK
H_B = 8
BACK_B = 8
REL_CLIP = 128
N_REL = 2 * REL_CLIP + 1
QA = H_A * HEAD_DIM
KVA = KV_A * HEAD_DIM
QB = H_B * HEAD_DIM
D_IN = QA + 2 * KVA + 3 * QB
SPLITS = (QA, QA + KVA, QA + 2 * KVA, QA + 2 * KVA + QB, QA + 2 * KVA + 2 * QB)
D_MIX = QA + QB
N_MOD = 9

kernel_name = "hybrid_chunk_causal_swa_sink_relbias_macaron"


def rms_norm(x, g):
    x32 = x.astype(jnp.float32)
    y = x32 * lax.rsqrt(jnp.mean(x32 * x32, axis=-1, keepdims=True) + EPS)
    return y.astype(x.dtype) * g


def swiglu(h, w_gate, w_up, w_down):
    return (jax.nn.silu(h @ w_gate) * (h @ w_up)) @ w_down


def chunk_band(t, n_back):
    b, s, h, d = t.shape
    n = s // CHUNK
    tc = t.reshape(b, n, CHUNK, h, d)
    tp = jnp.pad(tc, ((0, 0), (n_back, 0), (0, 0), (0, 0), (0, 0)))
    return jnp.concatenate([tp[:, j:j + n] for j in range(n_back + 1)], axis=2)


def band_distance(n_back):
    i = jnp.arange(CHUNK, dtype=jnp.int32)[:, None]
    j = jnp.arange((n_back + 1) * CHUNK, dtype=jnp.int32)[None, :]
    return n_back * CHUNK + i - j


def band_valid(n_chunks, n_back):
    kc = (jnp.arange(n_chunks, dtype=jnp.int32)[:, None] - n_back
          + jnp.arange((n_back + 1) * CHUNK, dtype=jnp.int32)[None, :] // CHUNK)
    return kc >= 0


def band_attention(q, k_band, v_band, bias, valid, sink):
    scale = q.shape[-1] ** -0.5
    s = jnp.einsum('bnqhgd,bnshd->bnhgqs', q, k_band).astype(jnp.float32) * scale
    s = jnp.where(valid[None, :, None, None, None, :], s + bias[None, None], NEG_INF)
    if sink is None:
        p = jax.nn.softmax(s, axis=-1)
    else:
        sk = sink.astype(jnp.float32)[None, None, :, :, None, None]
        m = jnp.maximum(jnp.max(s, axis=-1, keepdims=True), sk)
        e = jnp.exp(s - m)
        p = e / (jnp.sum(e, axis=-1, keepdims=True) + jnp.exp(sk - m))
    return jnp.einsum('bnhgqs,bnshd->bnqhgd', p.astype(v_band.dtype), v_band)


def alibi_slopes(n_heads):
    return jnp.asarray(np.array([2.0 ** (-8.0 * (i + 1) / n_heads) for i in range(n_heads)], dtype=np.float32))


def hybrid_mixer(h, w_in, b_in, sinks_a, rel_bias_b, g_grp_a, g_grp_b, w_out, b_out):
    b, s, _ = h.shape
    n = s // CHUNK
    proj = h @ w_in + b_in
    qa, ka, va, qb, kb, vb = jnp.split(proj, SPLITS, axis=-1)

    qa = qa.reshape(b, n, CHUNK, KV_A, G_A, HEAD_DIM)
    ka_band = chunk_band(ka.reshape(b, s, KV_A, HEAD_DIM), BACK_A)
    va_band = chunk_band(va.reshape(b, s, KV_A, HEAD_DIM), BACK_A)
    dist_a = jnp.abs(band_distance(BACK_A)).astype(jnp.float32)
    bias_a = (-alibi_slopes(H_A)[:, None, None] * dist_a[None]).reshape(KV_A, G_A, CHUNK, -1)
    oa = band_attention(qa, ka_band, va_band, bias_a, band_valid(n, BACK_A),
                        sinks_a.reshape(KV_A, G_A)).reshape(b, s, QA)

    qb = qb.reshape(b, n, CHUNK, H_B, 1, HEAD_DIM)
    kb_band = chunk_band(kb.reshape(b, s, H_B, HEAD_DIM), BACK_B)
    vb_band = chunk_band(vb.reshape(b, s, H_B, HEAD_DIM), BACK_B)
    rel_idx = jnp.clip(band_distance(BACK_B), -REL_CLIP, REL_CLIP) + REL_CLIP
    bias_b = rel_bias_b.astype(jnp.float32)[:, rel_idx][:, None]
    ob = band_attention(qb, kb_band, vb_band, bias_b, band_valid(n, BACK_B), None).reshape(b, s, QB)

    y = jnp.concatenate([rms_norm(oa, g_grp_a), rms_norm(ob, g_grp_b)], axis=-1)
    return y @ w_out + b_out


def sandwich(x, y_fn, g_pre, g_post, shift, scale, gate, weight):
    h = rms_norm(x, g_pre) * (1.0 + scale[:, None, :]) + shift[:, None, :]
    y = rms_norm(y_fn(h), g_post)
    return x + weight * gate[:, None, :] * y


def setup_inputs(seed: int = 0) -> dict:
    key = jax.random.key(seed)
    ks = jax.random.split(key, 32)
    f32 = jnp.float32

    def w(k, shape, fan_in, mult=1.0):
        return jax.random.normal(k, shape, f32) * (mult * fan_in ** -0.5)

    def gain(k, n):
        return 1.0 + 0.05 * jax.random.normal(k, (DEPTH, n), f32)

    def bias(k, n):
        return 0.02 * jax.random.normal(k, (DEPTH, n), f32)

    return {
        "x": jax.random.normal(ks[0], (BATCH, SEQ, D_MODEL), f32),
        "c": jax.random.normal(ks[1], (BATCH, D_MODEL), f32),
        "w_ada": w(ks[2], (DEPTH, D_MODEL, N_MOD * D_MODEL), D_MODEL, 0.3),
        "b_ada": bias(ks[3], N_MOD * D_MODEL),
        "g_pre_ffn1": gain(ks[4], D_MODEL),
        "w_gate1": w(ks[5], (DEPTH, D_MODEL, D_FF), D_MODEL),
        "w_up1": w(ks[6], (DEPTH, D_MODEL, D_FF), D_MODEL),
        "w_down1": w(ks[7], (DEPTH, D_FF, D_MODEL), D_FF),
        "g_post_ffn1": gain(ks[8], D_MODEL),
        "g_pre_mix": gain(ks[9], D_MODEL),
        "w_in": w(ks[10], (DEPTH, D_MODEL, D_IN), D_MODEL),
        "b_in": bias(ks[11], D_IN),
        "sinks_a": jax.random.normal(ks[12], (DEPTH, H_A), f32),
        "rel_bias_b": 0.5 * jax.random.normal(ks[13], (DEPTH, H_B, N_REL), f32),
        "g_grp_a": gain(ks[14], QA),
        "g_grp_b": gain(ks[15], QB),
        "w_out": w(ks[16], (DEPTH, D_MIX, D_MODEL), D_MIX),
        "b_out": bias(ks[17], D_MODEL),
        "g_post_mix": gain(ks[18], D_MODEL),
        "g_pre_ffn2": gain(ks[19], D_MODEL),
        "w_gate2": w(ks[20], (DEPTH, D_MODEL, D_FF), D_MODEL),
        "w_up2": w(ks[21], (DEPTH, D_MODEL, D_FF), D_MODEL),
        "w_down2": w(ks[22], (DEPTH, D_FF, D_MODEL), D_FF),
        "g_post_ffn2": gain(ks[23], D_MODEL),
    }


def reference(x, c, w_ada, b_ada, g_pre_ffn1, w_gate1, w_up1, w_down1, g_post_ffn1,
              g_pre_mix, w_in, b_in, sinks_a, rel_bias_b, g_grp_a, g_grp_b, w_out, b_out,
              g_post_mix, g_pre_ffn2, w_gate2, w_up2, w_down2, g_post_ffn2):
    bsz = c.shape[0]
    for l in range(DEPTH):
        mod = (jax.nn.silu(c) @ w_ada[l] + b_ada[l]).reshape(bsz, N_MOD, D_MODEL)
        x = sandwich(x, lambda h: swiglu(h, w_gate1[l], w_up1[l], w_down1[l]),
                     g_pre_ffn1[l], g_post_ffn1[l], mod[:, 0], mod[:, 1], mod[:, 2], 0.5)
        x = sandwich(x, lambda h: hybrid_mixer(h, w_in[l], b_in[l], sinks_a[l], rel_bias_b[l],
                                               g_grp_a[l], g_grp_b[l], w_out[l], b_out[l]),
                     g_pre_mix[l], g_post_mix[l], mod[:, 3], mod[:, 4], mod[:, 5], 1.0)
        x = sandwich(x, lambda h: swiglu(h, w_gate2[l], w_up2[l], w_down2[l]),
                     g_pre_ffn2[l], g_post_ffn2[l], mod[:, 6], mod[:, 7], mod[:, 8], 0.5)
    return x
```

```cpp
#include <hip/hip_runtime.h>
#include <cstdint>
#include <cmath>

namespace nv {
constexpr int Bz = 8, S = 2048, D = 1024, M = Bz * S, FF = 2816, DIN = 2304, NMODC = 9 * 1024;
constexpr float EPS = 1e-6f;

__global__ void __launch_bounds__(256) k_mod(const float* __restrict__ c, const float* __restrict__ w_ada, const float* __restrict__ b_ada, float* __restrict__ mod) {
    const int n = blockIdx.x * 256 + threadIdx.x, b = blockIdx.y;
    float acc = 0.f;
    for (int k = 0; k < D; ++k) { const float v = c[b * D + k]; const float s = v / (1.f + expf(-v)); acc += s * w_ada[(size_t)k * NMODC + n]; }
    mod[b * NMODC + n] = acc + b_ada[n];
}

__device__ __forceinline__ float block_sum256(float v, float* red) {
#pragma unroll
    for (int o = 32; o > 0; o >>= 1) v += __shfl_xor(v, o);
    const int w = threadIdx.x >> 6;
    __syncthreads();
    if ((threadIdx.x & 63) == 0) red[w] = v;
    __syncthreads();
    return red[0] + red[1] + red[2] + red[3];
}

__global__ void __launch_bounds__(256) k_prenorm(const float* __restrict__ x, const float* __restrict__ g, const float* __restrict__ mod, int shift_idx, int scale_idx, float* __restrict__ h) {
    __shared__ float red[4];
    const int row = blockIdx.x, b = row / S, t = threadIdx.x;
    const float4 v = ((const float4*)(x + (size_t)row * D))[t];
    const float ss = block_sum256(v.x * v.x + v.y * v.y + v.z * v.z + v.w * v.w, red);
    const float rstd = rsqrtf(ss * (1.f / D) + EPS);
    const float4 gg = ((const float4*)g)[t];
    const float4 sc = ((const float4*)(mod + (size_t)b * NMODC + scale_idx * D))[t];
    const float4 sh = ((const float4*)(mod + (size_t)b * NMODC + shift_idx * D))[t];
    float4 o;
    o.x = v.x * rstd * gg.x * (1.f + sc.x) + sh.x; o.y = v.y * rstd * gg.y * (1.f + sc.y) + sh.y;
    o.z = v.z * rstd * gg.z * (1.f + sc.z) + sh.z; o.w = v.w * rstd * gg.w * (1.f + sc.w) + sh.w;
    ((float4*)(h + (size_t)row * D))[t] = o;
}

__global__ void __launch_bounds__(256) k_postres(const float* x, const float* __restrict__ y, const float* __restrict__ g, const float* __restrict__ mod, int gate_idx, float weight, float* xo) {
    __shared__ float red[4];
    const int row = blockIdx.x, b = row / S, t = threadIdx.x;
    const float4 v = ((const float4*)(y + (size_t)row * D))[t];
    const float ss = block_sum256(v.x * v.x + v.y * v.y + v.z * v.z + v.w * v.w, red);
    const float rstd = rsqrtf(ss * (1.f / D) + EPS);
    const float4 gg = ((const float4*)g)[t];
    const float4 ga = ((const float4*)(mod + (size_t)b * NMODC + gate_idx * D))[t];
    const float4 xv = ((const float4*)(x + (size_t)row * D))[t];
    float4 o;
    o.x = xv.x + weight * ga.x * (v.x * rstd * gg.x); o.y = xv.y + weight * ga.y * (v.y * rstd * gg.y);
    o.z = xv.z + weight * ga.z * (v.z * rstd * gg.z); o.w = xv.w + weight * ga.w * (v.w * rstd * gg.w);
    ((float4*)(xo + (size_t)row * D))[t] = o;
}

template <bool DUAL>
__global__ void __launch_bounds__(256) k_gemm(const float* __restrict__ A, const float* __restrict__ W, const float* __restrict__ W2, const float* __restrict__ bias, float* __restrict__ C, int N, int K) {
    __shared__ float As[16][64 + 4];
    __shared__ float Ws[16][64];
    __shared__ float Ws2[DUAL ? 16 : 1][64];
    const int tid = threadIdx.x, tx = tid & 15, ty = tid >> 4;
    const int m0 = blockIdx.y * 64, n0 = blockIdx.x * 64;
    float acc[4][4] = {}, acc2[4][4] = {};
    for (int k0 = 0; k0 < K; k0 += 16) {
        { const int r = tid >> 2, kq = (tid & 3) * 4; const float4 a = *(const float4*)(A + (size_t)(m0 + r) * K + k0 + kq);
          As[kq + 0][r] = a.x; As[kq + 1][r] = a.y; As[kq + 2][r] = a.z; As[kq + 3][r] = a.w; }
        { const int kr = tid >> 4, nq = (tid & 15) * 4; *(float4*)&Ws[kr][nq] = *(const float4*)(W + (size_t)(k0 + kr) * N + n0 + nq);
          if (DUAL) *(float4*)&Ws2[kr][nq] = *(const float4*)(W2 + (size_t)(k0 + kr) * N + n0 + nq); }
        __syncthreads();
#pragma unroll
        for (int k = 0; k < 16; ++k) {
            const float4 a = *(const float4*)&As[k][ty * 4]; const float4 w = *(const float4*)&Ws[k][tx * 4];
            const float av[4] = {a.x, a.y, a.z, a.w}, wv[4] = {w.x, w.y, w.z, w.w};
#pragma unroll
            for (int i = 0; i < 4; ++i)
#pragma unroll
                for (int j = 0; j < 4; ++j) acc[i][j] += av[i] * wv[j];
            if (DUAL) { const float4 w2 = *(const float4*)&Ws2[k][tx * 4]; const float w2v[4] = {w2.x, w2.y, w2.z, w2.w};
#pragma unroll
                for (int i = 0; i < 4; ++i)
#pragma unroll
                    for (int j = 0; j < 4; ++j) acc2[i][j] += av[i] * w2v[j]; }
        }
        __syncthreads();
    }
#pragma unroll
    for (int i = 0; i < 4; ++i) {
        float o[4];
#pragma unroll
        for (int j = 0; j < 4; ++j) {
            float v = acc[i][j];
            if (DUAL) { v = v / (1.f + expf(-v)) * acc2[i][j]; }
            else if (bias) v += bias[n0 + tx * 4 + j];
            o[j] = v;
        }
        *(float4*)(C + (size_t)(m0 + ty * 4 + i) * N + n0 + tx * 4) = make_float4(o[0], o[1], o[2], o[3]);
    }
}

__global__ void __launch_bounds__(64) k_attn(const float* __restrict__ proj, const float* __restrict__ sinks, const float* __restrict__ relb, float* __restrict__ o) {
    __shared__ float q[64];
    __shared__ float p[576];
    const int tok = blockIdx.x, hh = blockIdx.y, lane = threadIdx.x;
    const int b = tok / S, t = tok % S, n = t / 64;
    const bool isA = hh < 8; const int h = isA ? hh : hh - 8;
    const int back = isA ? 2 : 8;
    const int qcol = isA ? h * 64 : 768 + h * 64;
    const int kcol = isA ? 512 + (h / 4) * 64 : 1280 + h * 64;
    const int vcol = isA ? 640 + (h / 4) * 64 : 1792 + h * 64;
    const float slope = exp2f(-(float)(h + 1));
    q[lane] = proj[(size_t)tok * DIN + qcol + lane];
    __syncthreads();
    const int kc0 = n - back, L = (back + 1) * 64;
    float mloc = -3.0e38f;
    for (int j = lane; j < L; j += 64) {
        const int kc = kc0 + j / 64; float s;
        if (kc < 0) s = -1e30f;
        else {
            const int spos = kc * 64 + (j % 64);
            const float* kr = proj + (size_t)(b * S + spos) * DIN + kcol;
            float d = 0.f;
            for (int e = 0; e < 64; ++e) d += q[e] * kr[e];
            s = d * 0.125f;
            const int dist = t - spos;
            if (isA) s += -slope * fabsf((float)dist);
            else { int idx = dist; idx = idx < -128 ? -128 : (idx > 128 ? 128 : idx); s += relb[h * 257 + idx + 128]; }
        }
        p[j] = s; mloc = fmaxf(mloc, s);
    }
#pragma unroll
    for (int off = 32; off > 0; off >>= 1) mloc = fmaxf(mloc, __shfl_xor(mloc, off));
    const float sk = isA ? sinks[h] : 0.f;
    const float m = isA ? fmaxf(mloc, sk) : mloc;
    float sum = 0.f;
    for (int j = lane; j < L; j += 64) { const float e = expf(p[j] - m); p[j] = e; sum += e; }
#pragma unroll
    for (int off = 32; off > 0; off >>= 1) sum += __shfl_xor(sum, off);
    if (isA) sum += expf(sk - m);
    __syncthreads();
    float acc = 0.f;
    for (int j = 0; j < L; ++j) { const int kc = kc0 + j / 64; if (kc < 0) continue; const int spos = kc * 64 + (j % 64);
        acc += p[j] * proj[(size_t)(b * S + spos) * DIN + vcol + lane]; }
    o[(size_t)tok * D + (isA ? h * 64 : 512 + h * 64) + lane] = acc / sum;
}

__global__ void __launch_bounds__(256) k_grpnorm(float* __restrict__ o, const float* __restrict__ ga, const float* __restrict__ gb) {
    __shared__ float red[4];
    const int tok = blockIdx.x, grp = blockIdx.y, t = threadIdx.x;
    float* p = o + (size_t)tok * D + grp * 512;
    const float2 v = ((const float2*)p)[t];
    const float ss = block_sum256(v.x * v.x + v.y * v.y, red);
    const float rstd = rsqrtf(ss * (1.f / 512) + EPS);
    const float2 gg = ((const float2*)(grp ? gb : ga))[t];
    ((float2*)p)[t] = make_float2(v.x * rstd * gg.x, v.y * rstd * gg.y);
}
}

extern "C" void kernel_launch(void* const* d_in, const int* in_sizes, int n_in, void* d_out, int out_size, void* d_ws, size_t ws_size, hipStream_t stream) {
    using namespace nv;
    const float* x = (const float*)d_in[0]; const float* c = (const float*)d_in[1]; const float* w_ada = (const float*)d_in[2]; const float* b_ada = (const float*)d_in[3];
    const float* g_pre1 = (const float*)d_in[4]; const float* wg1 = (const float*)d_in[5]; const float* wu1 = (const float*)d_in[6]; const float* wd1 = (const float*)d_in[7]; const float* g_post1 = (const float*)d_in[8];
    const float* g_prem = (const float*)d_in[9]; const float* w_in = (const float*)d_in[10]; const float* b_in = (const float*)d_in[11]; const float* sinks = (const float*)d_in[12]; const float* relb = (const float*)d_in[13];
    const float* g_ga = (const float*)d_in[14]; const float* g_gb = (const float*)d_in[15]; const float* w_out = (const float*)d_in[16]; const float* b_out = (const float*)d_in[17]; const float* g_postm = (const float*)d_in[18];
    const float* g_pre2 = (const float*)d_in[19]; const float* wg2 = (const float*)d_in[20]; const float* wu2 = (const float*)d_in[21]; const float* wd2 = (const float*)d_in[22]; const float* g_post2 = (const float*)d_in[23];
    float* out = (float*)d_out;
    char* ws = (char*)d_ws;
    const size_t MiB = 1u << 20;
    float* mod = (float*)ws; float* bufA = (float*)(ws + 1 * MiB); float* bufB = (float*)(ws + 65 * MiB);
    k_mod<<<dim3(NMODC / 256, Bz), 256, 0, stream>>>(c, w_ada, b_ada, mod);
    k_prenorm<<<M, 256, 0, stream>>>(x, g_pre1, mod, 0, 1, bufA);
    k_gemm<true><<<dim3(FF / 64, M / 64), 256, 0, stream>>>(bufA, wg1, wu1, nullptr, bufB, FF, D);
    k_gemm<false><<<dim3(D / 64, M / 64), 256, 0, stream>>>(bufB, wd1, nullptr, nullptr, bufA, D, FF);
    k_postres<<<M, 256, 0, stream>>>(x, bufA, g_post1, mod, 2, 0.5f, out);
    k_prenorm<<<M, 256, 0, stream>>>(out, g_prem, mod, 3, 4, bufA);
    k_gemm<false><<<dim3(DIN / 64, M / 64), 256, 0, stream>>>(bufA, w_in, nullptr, b_in, bufB, DIN, D);
    k_attn<<<dim3(M, 16), 64, 0, stream>>>(bufB, sinks, relb, bufA);
    k_grpnorm<<<dim3(M, 2), 256, 0, stream>>>(bufA, g_ga, g_gb);
    k_gemm<false><<<dim3(D / 64, M / 64), 256, 0, stream>>>(bufA, w_out, nullptr, b_out, bufB, D, D);
    k_postres<<<M, 256, 0, stream>>>(out, bufB, g_postm, mod, 5, 1.0f, out);
    k_prenorm<<<M, 256, 0, stream>>>(out, g_pre2, mod, 6, 7, bufA);
    k_gemm<true><<<dim3(FF / 64, M / 64), 256, 0, stream>>>(bufA, wg2, wu2, nullptr, bufB, FF, D);
    k_gemm<false><<<dim3(D / 64, M / 64), 256, 0, stream>>>(bufB, wd2, nullptr, nullptr, bufA, D, FF);
    k_postres<<<M, 256, 0, stream>>>(out, bufA, g_post2, mod, 8, 0.5f, out);
}
```
